# Optimizing an MI355X kernel written in HIP

```python
import jax, jax.numpy as jnp
from jax import lax
import numpy as np

D_MODEL = 1024
BATCH = 8
SEQ = 2048
DEPTH = 4
DEC_BATCH = 128
DEC_SEQ = 4
PAST_LEN = 16384
PAGE_SIZE = 128

A_HEADS = 8
A_HEAD_DIM = D_MODEL // A_HEADS
A_WIDTH = A_HEADS * A_HEAD_DIM
B_WIDTH = D_MODEL
CONV_W = 3
CHUNK = 64
DEEPNORM_ALPHA = (2 * DEPTH) ** 0.25
DEEPNORM_BETA = (8 * DEPTH) ** -0.25
LN_EPS = 1e-5
RMS_EPS = 1e-6
LB_FLOOR = 1e-30
PROJ_SIZES = (A_WIDTH, A_WIDTH, A_WIDTH, A_WIDTH, B_WIDTH, B_WIDTH, B_WIDTH, B_WIDTH, D_MODEL, D_MODEL)
N_PROJ = sum(PROJ_SIZES)

kernel_name = "hgrn2_shortconv_gated_parallel_deepnorm_step"


def layer_norm(x, g, b):
    xf = x.astype(jnp.float32)
    mu = jnp.mean(xf, axis=-1, keepdims=True)
    var = jnp.mean(jnp.square(xf - mu), axis=-1, keepdims=True)
    return ((xf - mu) * lax.rsqrt(var + LN_EPS) * g.astype(jnp.float32) + b.astype(jnp.float32)).astype(x.dtype)


def hgrn2_lower_bounds(lb_param):
    p = jax.nn.softmax(lb_param.astype(jnp.float32), axis=0)
    return jnp.cumsum(p, axis=0) - p[0]


def hgrn2_recurrence(q, log_f, k, v, s0):
    b, t, h, dk = q.shape
    c = CHUNK if t % CHUNK == 0 else t
    n = t // c

    def to_chunks(a):
        return a.reshape(b, n, c, h, a.shape[-1]).transpose(1, 0, 3, 2, 4)

    causal = jnp.tril(jnp.ones((c, c), dtype=bool))[:, :, None]

    def step(s, inp):
        qi, gi, ki, vi = inp
        g_cum = jnp.cumsum(gi, axis=2)
        o_inter = jnp.einsum('bhtk,bhkv->bhtv', qi * jnp.exp(g_cum), s)
        diff = g_cum[:, :, :, None, :] - g_cum[:, :, None, :, :]
        decay = jnp.where(causal, jnp.exp(jnp.where(causal, diff, 0.0)), 0.0)
        attn = jnp.einsum('bhtk,bhsk,bhtsk->bhts', qi, ki, decay)
        o = o_inter + jnp.einsum('bhts,bhsv->bhtv', attn, vi)
        g_last = g_cum[:, :, -1:, :]
        k_dec = ki * jnp.exp(g_last - g_cum)
        s_new = jnp.exp(g_last[:, :, 0, :])[..., None] * s + jnp.einsum('bhsk,bhsv->bhkv', k_dec, vi)
        return s_new, o

    s_fin, o = lax.scan(step, s0, (to_chunks(q), to_chunks(log_f), to_chunks(k), to_chunks(v)))
    o = o.transpose(1, 0, 3, 2, 4).reshape(b, t, h, v.shape[-1])
    return o, s_fin


def short_conv(u, buf, w):
    t = u.shape[1]
    ext = jnp.concatenate([buf.astype(u.dtype), u], axis=1)
    y = ext[:, 0:t] * w[0]
    for j in range(1, CONV_W):
        y = y + ext[:, j:j + t] * w[j]
    return y, ext[:, -(CONV_W - 1):]


def trunk_layer(x, c, conv_buf, s0, lb, w_ada, b_ada, w_in, gnorm, conv_w, w_a_out, w_b_out, w_o, ln_g, ln_b):
    dt = x.dtype
    bsz, t, _ = x.shape
    ada = jnp.einsum('bd,de->be', jax.nn.silu(c), w_ada) + b_ada
    shift, scale, gate = jnp.split(ada, 3, axis=-1)
    h = x * (1 + scale[:, None, :]) + shift[:, None, :]
    proj = jnp.einsum('btd,de->bte', h, w_in)
    split_at = [int(s) for s in np.cumsum(PROJ_SIZES)[:-1]]
    q, fz, iv, ga, bg, cg, hv, gb, ra, rb = jnp.split(proj, split_at, axis=-1)

    def heads(a):
        return a.reshape(bsz, t, A_HEADS, A_HEAD_DIM).astype(jnp.float32)
    fz32 = heads(fz)
    lb_h = lb.reshape(A_HEADS, A_HEAD_DIM)
    log_f = jnp.logaddexp(jnp.log(jnp.maximum(lb_h, LB_FLOOR)), jnp.log1p(-lb_h) + jax.nn.log_sigmoid(fz32))
    k = (1 - lb_h) * jax.nn.sigmoid(-fz32)
    qh = jax.nn.silu(heads(q)) * (A_HEAD_DIM ** -0.5)
    o, s_new = hgrn2_recurrence(qh, log_f, k, heads(iv), s0.astype(jnp.float32))
    o = o * lax.rsqrt(jnp.mean(o * o, axis=-1, keepdims=True) + RMS_EPS) * gnorm.astype(jnp.float32).reshape(A_HEADS, A_HEAD_DIM)
    ya = jnp.einsum('btw,wd->btd', o.reshape(bsz, t, A_WIDTH).astype(dt) * jax.nn.silu(ga), w_a_out)

    v, buf_new = short_conv(cg * hv, conv_buf, conv_w)
    yb = jnp.einsum('btw,wd->btd', bg * v * jax.nn.silu(gb), w_b_out)

    m = jax.nn.sigmoid(ra) * ya + jax.nn.sigmoid(rb) * yb
    out = jnp.einsum('btd,de->bte', m, w_o)
    x_new = layer_norm(DEEPNORM_ALPHA * x + gate[:, None, :] * out, ln_g, ln_b)
    return x_new, buf_new, s_new


def run_trunk(x, c, conv_bufs, s0s, lbs, w_ada, b_ada, w_in, hgrn_gnorm, conv_w, w_a_out, w_b_out, w_o, ln_g, ln_b, state_dtype):
    hgrn_states = []
    conv_states = []
    for l in range(DEPTH):
        x, buf_new, s_new = trunk_layer(x, c, conv_bufs[l], s0s[l], lbs[l], w_ada[l], b_ada[l], w_in[l], hgrn_gnorm[l],
                                        conv_w[l], w_a_out[l], w_b_out[l], w_o[l], ln_g[l], ln_b[l])
        hgrn_states.append(s_new.astype(state_dtype))
        conv_states.append(buf_new.astype(state_dtype))
    return x, jnp.stack(hgrn_states), jnp.stack(conv_states)


def setup_inputs(seed: int = 0) -> dict:
    key = jax.random.key(seed)
    ks = jax.random.split(key, 20)
    f32 = jnp.float32
    x_prompt = jax.random.normal(ks[0], (BATCH, SEQ, D_MODEL), f32)
    x_sample = jax.random.normal(ks[1], (DEC_BATCH, DEC_SEQ, D_MODEL), f32)
    state_hgrn = 0.5 * jax.random.normal(ks[2], (DEPTH, DEC_BATCH, A_HEADS, A_HEAD_DIM, A_HEAD_DIM), f32)
    state_conv = jax.random.normal(ks[3], (DEPTH, DEC_BATCH, CONV_W - 1, B_WIDTH), f32)
    c_prompt = jax.random.normal(ks[4], (BATCH, D_MODEL), f32)
    c_sample = jax.random.normal(ks[5], (DEC_BATCH, D_MODEL), f32)
    w_ada = jax.random.normal(ks[6], (DEPTH, D_MODEL, 3 * D_MODEL), f32) * D_MODEL ** -0.5
    b_ada = 0.02 * jax.random.normal(ks[7], (DEPTH, 3 * D_MODEL), f32)
    w_in = jax.random.normal(ks[8], (DEPTH, D_MODEL, N_PROJ), f32) * D_MODEL ** -0.5
    hgrn_lb = 0.1 * jax.random.normal(ks[9], (DEPTH, A_WIDTH), f32)
    hgrn_gnorm = 1.0 + 0.01 * jax.random.normal(ks[10], (DEPTH, A_WIDTH), f32)
    conv_w = jax.random.normal(ks[11], (DEPTH, CONV_W, B_WIDTH), f32) * CONV_W ** -0.5
    w_a_out = jax.random.normal(ks[12], (DEPTH, A_WIDTH, D_MODEL), f32) * (A_WIDTH ** -0.5) * DEEPNORM_BETA
    w_b_out = jax.random.normal(ks[13], (DEPTH, B_WIDTH, D_MODEL), f32) * (B_WIDTH ** -0.5) * DEEPNORM_BETA
    w_o = jax.random.normal(ks[14], (DEPTH, D_MODEL, D_MODEL), f32) * (D_MODEL ** -0.5) * DEEPNORM_BETA
    ln_g = 1.0 + 0.01 * jax.random.normal(ks[15], (DEPTH, D_MODEL), f32)
    ln_b = 0.01 * jax.random.normal(ks[16], (DEPTH, D_MODEL), f32)
    return {"x_prompt": x_prompt, "x_sample": x_sample, "state_hgrn": state_hgrn, "state_conv": state_conv,
            "c_prompt": c_prompt, "c_sample": c_sample, "w_ada": w_ada, "b_ada": b_ada, "w_in": w_in,
            "hgrn_lb": hgrn_lb, "hgrn_gnorm": hgrn_gnorm, "conv_w": conv_w, "w_a_out": w_a_out,
            "w_b_out": w_b_out, "w_o": w_o, "ln_g": ln_g, "ln_b": ln_b}


def reference(x_prompt, x_sample, state_hgrn, state_conv, c_prompt, c_sample, w_ada, b_ada, w_in, hgrn_lb,
              hgrn_gnorm, conv_w, w_a_out, w_b_out, w_o, ln_g, ln_b):
    lbs = hgrn2_lower_bounds(hgrn_lb)
    sd = state_hgrn.dtype
    zero_hgrn = jnp.zeros((DEPTH, BATCH, A_HEADS, A_HEAD_DIM, A_HEAD_DIM), jnp.float32)
    zero_conv = jnp.zeros((DEPTH, BATCH, CONV_W - 1, B_WIDTH), x_prompt.dtype)
    y_prompt, new_hgrn_prompt, new_conv_prompt = run_trunk(
        x_prompt, c_prompt, zero_conv, zero_hgrn, lbs, w_ada, b_ada, w_in, hgrn_gnorm, conv_w,
        w_a_out, w_b_out, w_o, ln_g, ln_b, sd)
    y_sample, new_hgrn_sample, new_conv_sample = run_trunk(
        x_sample, c_sample, state_conv, state_hgrn, lbs, w_ada, b_ada, w_in, hgrn_gnorm, conv_w,
        w_a_out, w_b_out, w_o, ln_g, ln_b, sd)
    return (y_prompt, y_sample, new_hgrn_prompt, new_conv_prompt, new_hgrn_sample, new_conv_sample)
```

```cpp
#include <hip/hip_runtime.h>
#include <cstdint>
#include <cstdio>

typedef unsigned short bf16_t;
typedef short bf16x8 __attribute__((ext_vector_type(8)));
typedef float f32x4 __attribute__((ext_vector_type(4)));

constexpr int D = 1024, NBP = 8, SEQ = 2048, DEPTH = 4, NBS = 128, DSEQ = 4;
constexpr int TP = NBP * SEQ, TS = NBS * DSEQ, T = TP + TS, NSEQ = NBP + NBS;
constexpr int NPROJ = 10240, NH = 8, HD = 128;
constexpr float LN_EPS = 1e-5f, RMS_EPS = 1e-6f;
constexpr float DN_ALPHA = 1.681792830507429f;
constexpr float QSCALE = 0.08838834764831845f;

constexpr size_t O_Y = 0, O_HP = (size_t)T * D, O_CP = O_HP + (size_t)DEPTH * NBP * NH * HD * HD,
                 O_HS = O_CP + (size_t)DEPTH * NBP * 2 * D, O_CS = O_HS + (size_t)DEPTH * NBS * NH * HD * HD,
                 O_END = O_CS + (size_t)DEPTH * NBS * 2 * D;

__device__ __forceinline__ bf16_t f2bf(float f) { unsigned u = __float_as_uint(f); return (bf16_t)((u + 0x7fffu + ((u >> 16) & 1u)) >> 16); }
__device__ __forceinline__ float bf2f(bf16_t b) { return __uint_as_float(((unsigned)b) << 16); }
__device__ __forceinline__ float sigmoidf_(float x) { return 1.0f / (1.0f + __expf(-x)); }
__device__ __forceinline__ float siluf_(float x) { return x / (1.0f + __expf(-x)); }
__device__ __forceinline__ int seq_of_row(int r) { return r < TP ? (r >> 11) : NBP + ((r - TP) >> 2); }

__global__ void k_lbs(const float* __restrict__ lbp, float* __restrict__ lbs) {
    int j = blockIdx.x * blockDim.x + threadIdx.x; if (j >= D) return;
    float v[DEPTH], mx = -1e30f;
    for (int i = 0; i < DEPTH; ++i) { v[i] = lbp[i * D + j]; mx = fmaxf(mx, v[i]); }
    float s = 0.f; for (int i = 0; i < DEPTH; ++i) { v[i] = expf(v[i] - mx); s += v[i]; }
    float c = 0.f; lbs[j] = 0.f;
    for (int i = 1; i < DEPTH; ++i) { c += v[i] / s; lbs[i * D + j] = c; }
}

__global__ __launch_bounds__(256) void k_ada(const float* __restrict__ cp, const float* __restrict__ cs, const float* __restrict__ w_ada,
                                             const float* __restrict__ b_ada, float* __restrict__ ada) {
    __shared__ float sc[8][D];
    const int l = blockIdx.z, s0 = blockIdx.y * 8, e = blockIdx.x * 256 + threadIdx.x;
    for (int i = threadIdx.x; i < 8 * D; i += 256) { int s = s0 + i / D, d = i % D; float c = s < NBP ? cp[s * D + d] : cs[(s - NBP) * D + d]; sc[i / D][d] = siluf_(c); }
    __syncthreads();
    float acc[8]; for (int j = 0; j < 8; ++j) acc[j] = 0.f;
    const float* w = w_ada + (size_t)l * D * 3 * D + e;
    for (int d = 0; d < D; ++d) { float wv = w[(size_t)d * 3 * D]; for (int j = 0; j < 8; ++j) acc[j] += sc[j][d] * wv; }
    float b = b_ada[l * 3 * D + e];
    for (int j = 0; j < 8; ++j) ada[((size_t)l * NSEQ + s0 + j) * 3 * D + e] = acc[j] + b;
}

__global__ __launch_bounds__(256) void k_wt(const float* __restrict__ W, bf16_t* __restrict__ Wt, int K, int N) {
    __shared__ float tile[32][33];
    const int k0 = blockIdx.y * 32, n0 = blockIdx.x * 32, tx = threadIdx.x & 31, ty = threadIdx.x >> 5;
    for (int i = ty; i < 32; i += 8) tile[i][tx] = W[(size_t)(k0 + i) * N + n0 + tx];
    __syncthreads();
    for (int i = ty; i < 32; i += 8) Wt[(size_t)(n0 + i) * K + k0 + tx] = f2bf(tile[tx][i]);
}

__global__ __launch_bounds__(256) void k_modulate(const float* __restrict__ xp, const float* __restrict__ xs, const float* __restrict__ ada_l, bf16_t* __restrict__ H) {
    size_t i = (size_t)blockIdx.x * 256 + threadIdx.x; if (i >= (size_t)T * D) return;
    int r = (int)(i >> 10), d = (int)(i & 1023), s = seq_of_row(r);
    float x = r < TP ? xp[i] : xs[i - (size_t)TP * D];
    const float* a = ada_l + (size_t)s * 3 * D;
    H[i] = f2bf(x * (1.f + a[D + d]) + a[d]);
}

template <class Epi>
__global__ __launch_bounds__(256) void k_sgemm(const bf16_t* __restrict__ A, const bf16_t* __restrict__ Bt, int lda, int ldb, int K, int pad_, Epi epi) {
    const int lane = threadIdx.x & 63, w = threadIdx.x >> 6, fr = lane & 15, fq = lane >> 4;
    const int row0 = blockIdx.y * 128 + (w >> 1) * 64, col0 = blockIdx.x * 128 + (w & 1) * 64;
    f32x4 acc[4][4];
#pragma unroll
    for (int i = 0; i < 4; ++i)
#pragma unroll
        for (int j = 0; j < 4; ++j) acc[i][j] = (f32x4){0.f, 0.f, 0.f, 0.f};
    for (int k0 = 0; k0 < K; k0 += 32) {
        bf16x8 a[4], b[4];
#pragma unroll
        for (int i = 0; i < 4; ++i) a[i] = *(const bf16x8*)(A + (size_t)(row0 + i * 16 + fr) * lda + k0 + fq * 8);
#pragma unroll
        for (int j = 0; j < 4; ++j) b[j] = *(const bf16x8*)(Bt + (size_t)(col0 + j * 16 + fr) * ldb + k0 + fq * 8);
#pragma unroll
        for (int i = 0; i < 4; ++i)
#pragma unroll
            for (int j = 0; j < 4; ++j) acc[i][j] = __builtin_amdgcn_mfma_f32_16x16x32_bf16(a[i], b[j], acc[i][j], 0, 0, 0);
    }
#pragma unroll
    for (int i = 0; i < 4; ++i)
#pragma unroll
        for (int j = 0; j < 4; ++j)
#pragma unroll
            for (int e = 0; e < 4; ++e) epi(row0 + i * 16 + fq * 4 + e, col0 + j * 16 + fr, acc[i][j][e]);
}

struct EpiRawF32 { float* C; int ldc; int pad_; __device__ void operator()(int r, int c, float v) const { C[(size_t)r * ldc + c] = v; } };
struct EpiBranchA {
    bf16_t *QS, *KK, *VV, *GA; float* GL; const float* lbs_l;
    __device__ void operator()(int r, int c, float v) const {
        const int g = c >> 10, j = c & 1023; const size_t o = (size_t)r * D + j;
        if (g == 0) QS[o] = f2bf(siluf_(v) * QSCALE);
        else if (g == 1) { const float lb = lbs_l[j]; const float sg = 1.f / (1.f + __expf(-v)), sn = 1.f / (1.f + __expf(v));
            GL[o] = __logf(lb + (1.f - lb) * sg); KK[o] = f2bf((1.f - lb) * sn); }
        else if (g == 2) VV[o] = f2bf(v);
        else GA[o] = f2bf(siluf_(v));
    }
};
struct EpiSig { bf16_t *RA, *RB; __device__ void operator()(int r, int c, float v) const { const int g = c >> 10, j = c & 1023; (g ? RB : RA)[(size_t)r * D + j] = f2bf(sigmoidf_(v)); } };

__global__ __launch_bounds__(256) void k_postB(const float* __restrict__ tmp, bf16_t* __restrict__ PB, bf16_t* __restrict__ UU, float* __restrict__ out, int l, int pad_) {
    size_t i = (size_t)blockIdx.x * 256 + threadIdx.x; if (i >= (size_t)T * D) return;
    int r = (int)(i >> 10), j = (int)(i & 1023);
    const float* p = tmp + (size_t)r * 4096 + j;
    float bg = p[0], cg = p[1024], hv = p[2048], gb = p[3072], u = cg * hv;
    PB[i] = f2bf(bg * siluf_(gb)); UU[i] = f2bf(u);
    if (r < TP) { int b = r >> 11, t = r & 2047; if (t >= SEQ - 2) out[O_CP + (((size_t)l * NBP + b) * 2 + (t - (SEQ - 2))) * D + j] = u; }
    else { int rr = r - TP, b = rr >> 2, t = rr & 3; if (t >= DSEQ - 2) out[O_CS + (((size_t)l * NBS + b) * 2 + (t - (DSEQ - 2))) * D + j] = u; }
}

__global__ __launch_bounds__(256) void k_convprep(const bf16_t* __restrict__ PB, const bf16_t* __restrict__ UU, const float* __restrict__ conv_w,
                                                  const float* __restrict__ state_conv, bf16_t* __restrict__ AB, int l, int pad_) {
    size_t i = (size_t)blockIdx.x * 256 + threadIdx.x; if (i >= (size_t)T * D) return;
    int r = (int)(i >> 10), j = (int)(i & 1023);
    const float w0 = conv_w[(l * 3 + 0) * D + j], w1 = conv_w[(l * 3 + 1) * D + j], w2 = conv_w[(l * 3 + 2) * D + j];
    float e0, e1, e2 = bf2f(UU[i]);
    if (r < TP) { int t = r & 2047; e1 = t >= 1 ? bf2f(UU[i - D]) : 0.f; e0 = t >= 2 ? bf2f(UU[i - 2 * D]) : 0.f; }
    else { int rr = r - TP, b = rr >> 2, t = rr & 3; const float* buf = state_conv + ((size_t)l * NBS + b) * 2 * D + j;
        e1 = t >= 1 ? bf2f(UU[i - D]) : buf[D]; e0 = t >= 2 ? bf2f(UU[i - 2 * D]) : buf[t * D]; }
    AB[(size_t)r * 2 * D + D + j] = f2bf(bf2f(PB[i]) * (e0 * w0 + e1 * w1 + e2 * w2));
}

__global__ __launch_bounds__(256) void k_recur_ref(const bf16_t* __restrict__ QS, const float* __restrict__ GL, const bf16_t* __restrict__ KK,
                                                   const bf16_t* __restrict__ VV, const bf16_t* __restrict__ GA, const float* __restrict__ gnorm,
                                                   const float* __restrict__ state_in, bf16_t* __restrict__ AB, float* __restrict__ out, int l, int pad_) {
    __shared__ float sq[128], sf[128], sk[128], sv[128], sp[256], red[2];
    const int s = blockIdx.x >> 3, h = blockIdx.x & 7, tid = threadIdx.x, vv = tid & 127, kh = tid >> 7;
    int row0, nt; const float* s0 = nullptr; float* so;
    if (s < NBP) { row0 = s * SEQ; nt = SEQ; so = out + O_HP + (((size_t)l * NBP + s) * NH + h) * HD * HD; }
    else { int b = s - NBP; row0 = TP + b * DSEQ; nt = DSEQ; s0 = state_in + (((size_t)l * NBS + b) * NH + h) * HD * HD; so = out + O_HS + (((size_t)l * NBS + b) * NH + h) * HD * HD; }
    float S[64];
#pragma unroll
    for (int i = 0; i < 64; ++i) S[i] = s0 ? s0[(kh * 64 + i) * HD + vv] : 0.f;
    const int c = h * HD;
    for (int t = 0; t < nt; ++t) {
        const size_t ro = (size_t)(row0 + t) * D + c;
        if (tid < 128) { sq[tid] = bf2f(QS[ro + tid]); sf[tid] = __expf(GL[ro + tid]); }
        else { sk[tid - 128] = bf2f(KK[ro + tid - 128]); sv[tid - 128] = bf2f(VV[ro + tid - 128]); }
        __syncthreads();
        const float vt = sv[vv]; float p = 0.f;
#pragma unroll
        for (int i = 0; i < 64; ++i) { const int k = kh * 64 + i; S[i] = sf[k] * S[i] + sk[k] * vt; p += S[i] * sq[k]; }
        sp[tid] = p;
        __syncthreads();
        float o = 0.f;
        if (tid < 128) { o = sp[tid] + sp[tid + 128]; float q = o * o;
            for (int m = 1; m < 64; m <<= 1) q += __shfl_xor(q, m);
            if ((tid & 63) == 0) red[tid >> 6] = q; }
        __syncthreads();
        if (tid < 128) { const float rinv = rsqrtf((red[0] + red[1]) * (1.f / HD) + RMS_EPS);
            AB[(size_t)(row0 + t) * 2 * D + c + tid] = f2bf(o * rinv * gnorm[l * D + c + tid] * bf2f(GA[ro + tid])); }
    }
#pragma unroll
    for (int i = 0; i < 64; ++i) so[(kh * 64 + i) * HD + vv] = S[i];
}

__global__ __launch_bounds__(256) void k_merge(const float* __restrict__ T1, const float* __restrict__ T2, const bf16_t* __restrict__ RA, const bf16_t* __restrict__ RB, bf16_t* __restrict__ M) {
    size_t i = (size_t)blockIdx.x * 256 + threadIdx.x; if (i >= (size_t)T * D) return;
    M[i] = f2bf(bf2f(RA[i]) * T1[i] + bf2f(RB[i]) * T2[i]);
}

__global__ __launch_bounds__(256) void k_ln(const float* __restrict__ xp, const float* __restrict__ xs, const float* __restrict__ T1, const float* __restrict__ ada_l,
                                            const float* __restrict__ ln_g, const float* __restrict__ ln_b, float* __restrict__ Y, int l, int pad_) {
    const int r = blockIdx.x * 4 + (threadIdx.x >> 6), lane = threadIdx.x & 63; if (r >= T) return;
    const int s = seq_of_row(r);
    const float* x = r < TP ? xp + (size_t)r * D : xs + (size_t)(r - TP) * D;
    const float* gate = ada_l + (size_t)s * 3 * D + 2 * D;
    float v[16], sum = 0.f;
#pragma unroll
    for (int i = 0; i < 16; ++i) { int d = lane + 64 * i; v[i] = DN_ALPHA * x[d] + gate[d] * T1[(size_t)r * D + d]; sum += v[i]; }
    for (int m = 1; m < 64; m <<= 1) sum += __shfl_xor(sum, m);
    const float mean = sum * (1.f / D); float q = 0.f;
#pragma unroll
    for (int i = 0; i < 16; ++i) { v[i] -= mean; q += v[i] * v[i]; }
    for (int m = 1; m < 64; m <<= 1) q += __shfl_xor(q, m);
    const float rstd = rsqrtf(q * (1.f / D) + LN_EPS);
#pragma unroll
    for (int i = 0; i < 16; ++i) { int d = lane + 64 * i; Y[(size_t)r * D + d] = v[i] * rstd * ln_g[l * D + d] + ln_b[l * D + d]; }
}

constexpr size_t MiB = 1u << 20;
constexpr size_t SZ_ACT = (size_t)T * D * 2;
constexpr size_t WS_LBS = 0, WS_ADA = 1 * MiB, WS_WIN = 8 * MiB  , WS_WA = 28 * MiB, WS_WB = 30 * MiB, WS_WO = 32 * MiB,
                 WS_H = 34 * MiB, WS_QS = WS_H + SZ_ACT, WS_KK = WS_QS + SZ_ACT, WS_VV = WS_KK + SZ_ACT, WS_GA = WS_VV + SZ_ACT, WS_PB = WS_GA + SZ_ACT,
                 WS_UU = WS_PB + SZ_ACT, WS_RA = WS_UU + SZ_ACT, WS_RB = WS_RA + SZ_ACT, WS_M = WS_RB + SZ_ACT, WS_AB = WS_M + SZ_ACT, WS_GL = WS_AB + 2 * SZ_ACT,
                 WS_TMP = WS_GL + 2 * SZ_ACT, WS_END = WS_TMP + (size_t)T * 4096 * 4;

extern "C" void kernel_launch(void* const* d_in, const int* in_sizes, int n_in, void* d_out, int out_size, void* d_ws, size_t ws_size, hipStream_t stream) {
    if (n_in != 17 || (size_t)out_size != O_END || ws_size < WS_END) { fprintf(stderr, "kernel_launch: unexpected sizes n_in %d out %d ws %zu (need %zu)\n", n_in, out_size, ws_size, (size_t)WS_END); return; }
    const float* x_prompt = (const float*)d_in[0]; const float* x_sample = (const float*)d_in[1]; const float* state_hgrn = (const float*)d_in[2];
    const float* state_conv = (const float*)d_in[3]; const float* c_prompt = (const float*)d_in[4]; const float* c_sample = (const float*)d_in[5];
    const float* w_ada = (const float*)d_in[6]; const float* b_ada = (const float*)d_in[7]; const float* w_in = (const float*)d_in[8];
    const float* hgrn_lb = (const float*)d_in[9]; const float* hgrn_gnorm = (const float*)d_in[10]; const float* conv_w = (const float*)d_in[11];
    const float* w_a_out = (const float*)d_in[12]; const float* w_b_out = (const float*)d_in[13]; const float* w_o = (const float*)d_in[14];
    const float* ln_g = (const float*)d_in[15]; const float* ln_b = (const float*)d_in[16];
    float* out = (float*)d_out; char* ws = (char*)d_ws;
    float* lbs = (float*)(ws + WS_LBS); float* ada = (float*)(ws + WS_ADA);
    bf16_t *win_t = (bf16_t*)(ws + WS_WIN), *wa_t = (bf16_t*)(ws + WS_WA), *wb_t = (bf16_t*)(ws + WS_WB), *wo_t = (bf16_t*)(ws + WS_WO);
    bf16_t *H = (bf16_t*)(ws + WS_H), *QS = (bf16_t*)(ws + WS_QS), *KK = (bf16_t*)(ws + WS_KK), *VV = (bf16_t*)(ws + WS_VV), *GA = (bf16_t*)(ws + WS_GA),
           *PB = (bf16_t*)(ws + WS_PB), *UU = (bf16_t*)(ws + WS_UU), *RA = (bf16_t*)(ws + WS_RA), *RB = (bf16_t*)(ws + WS_RB), *M = (bf16_t*)(ws + WS_M), *AB = (bf16_t*)(ws + WS_AB);
    float* GL = (float*)(ws + WS_GL); float* tmp = (float*)(ws + WS_TMP); float* T1 = tmp; float* T2 = tmp + (size_t)T * D;
    const int EW = (int)(((size_t)T * D + 255) / 256);

    k_lbs<<<D / 256, 256, 0, stream>>>(hgrn_lb, lbs);
    k_ada<<<dim3(3 * D / 256, NSEQ / 8, DEPTH), 256, 0, stream>>>(c_prompt, c_sample, w_ada, b_ada, ada);
    for (int l = 0; l < DEPTH; ++l) {
        const float* ada_l = ada + (size_t)l * NSEQ * 3 * D;
        const float* xp = l == 0 ? x_prompt : out + O_Y; const float* xs = l == 0 ? x_sample : out + O_Y + (size_t)TP * D;
        k_wt<<<dim3(NPROJ / 32, D / 32), 256, 0, stream>>>(w_in + (size_t)l * D * NPROJ, win_t, D, NPROJ);
        k_wt<<<dim3(D / 32, D / 32), 256, 0, stream>>>(w_a_out + (size_t)l * D * D, wa_t, D, D);
        k_wt<<<dim3(D / 32, D / 32), 256, 0, stream>>>(w_b_out + (size_t)l * D * D, wb_t, D, D);
        k_wt<<<dim3(D / 32, D / 32), 256, 0, stream>>>(w_o + (size_t)l * D * D, wo_t, D, D);
        k_modulate<<<EW, 256, 0, stream>>>(xp, xs, ada_l, H);
        k_sgemm<EpiBranchA><<<dim3(4096 / 128, T / 128), 256, 0, stream>>>(H, win_t, D, D, D, 0, EpiBranchA{QS, KK, VV, GA, GL, lbs + l * D});
        k_sgemm<EpiRawF32><<<dim3(4096 / 128, T / 128), 256, 0, stream>>>(H, win_t + (size_t)4096 * D, D, D, D, 0, EpiRawF32{tmp, 4096, 0});
        k_sgemm<EpiSig><<<dim3(2048 / 128, T / 128), 256, 0, stream>>>(H, win_t + (size_t)8192 * D, D, D, D, 0, EpiSig{RA, RB});
        k_postB<<<EW, 256, 0, stream>>>(tmp, PB, UU, out, l, 0);
        k_convprep<<<EW, 256, 0, stream>>>(PB, UU, conv_w, state_conv, AB, l, 0);
        k_recur_ref<<<NSEQ * NH, 256, 0, stream>>>(QS, GL, KK, VV, GA, hgrn_gnorm, state_hgrn, AB, out, l, 0);
        k_sgemm<EpiRawF32><<<dim3(D / 128, T / 128), 256, 0, stream>>>(AB, wa_t, 2 * D, D, D, 0, EpiRawF32{T1, D, 0});
        k_sgemm<EpiRawF32><<<dim3(D / 128, T / 128), 256, 0, stream>>>(AB + D, wb_t, 2 * D, D, D, 0, EpiRawF32{T2, D, 0});
        k_merge<<<EW, 256, 0, stream>>>(T1, T2, RA, RB, M);
        k_sgemm<EpiRawF32><<<dim3(D / 128, T / 128), 256, 0, stream>>>(M, wo_t, D, D, D, 0, EpiRawF32{T1, D, 0});
        k_ln<<<T / 4, 256, 0, stream>>>(xp, xs, T1, ada_l, ln_g, ln_b, out + O_Y, l, 0);
    }
}
```
